# Optimizing an MI355X kernel written in HIP

```python
import math
import jax, jax.numpy as jnp
from jax import lax
import numpy as np

D_MODEL = 2048
BATCH = 1
SEQ = 8192
DEPTH = 1

CHUNK = 64
Q_BLOCK = 128
D_MIX = D_MODEL
M_HEADS = 4
M_DV = D_MIX // 2 // M_HEADS
M_DQK = M_DV // 2
M_QK = 2 * M_HEADS * M_DQK
CONV_W = 4
A_HEADS = 4
A_DV = D_MIX // 2 // A_HEADS
A_DQK = A_DV // 2
D_FF = -(-8 * D_MODEL // (3 * 256)) * 256
RMS_EPS = 1e-6
NEG = -1e30
IN_SIZES = (M_QK, M_HEADS * M_DV, M_HEADS * M_DV, M_HEADS, M_HEADS,
            A_HEADS * 2 * A_DQK, A_HEADS * 2 * A_DQK, A_HEADS * A_DV)
N_IN = sum(IN_SIZES)

kernel_name = 'hymba_mlstm_diffattn_block'


def rms_norm(x, g):
    xf = x.astype(jnp.float32)
    y = xf * lax.rsqrt(jnp.mean(xf * xf, axis=-1, keepdims=True) + RMS_EPS)
    return (y * g.astype(jnp.float32)).astype(x.dtype)


def causal_dwconv(x, w, b):
    c = x.shape[-1]
    y = lax.conv_general_dilated(x, w[:, None, :].astype(x.dtype), window_strides=(1,),
                                 padding=[(CONV_W - 1, 0)],
                                 dimension_numbers=('NWC', 'WIO', 'NWC'),
                                 feature_group_count=c)
    return y + b.astype(x.dtype)


def mlstm_chunkwise(q, k, v, i_pre, f_pre):
    B, H, S, dqk = q.shape
    dv = v.shape[-1]
    L = CHUNK
    NC = S // L
    f32 = jnp.float32
    qc = q.astype(f32).reshape(B, H, NC, L, dqk)
    kc = k.astype(f32).reshape(B, H, NC, L, dqk)
    vc = v.astype(f32).reshape(B, H, NC, L, dv)
    log_f = jax.nn.log_sigmoid(f_pre).reshape(B, H, NC, L)
    log_i = i_pre.reshape(B, H, NC, L)
    b = jnp.cumsum(log_f, axis=-1)
    g = b[..., -1]
    a = g[..., None] - b + log_i
    m_loc = jnp.max(a, axis=-1)
    w_loc = jnp.exp(a - m_loc[..., None])
    C_loc = jnp.einsum('bhcs,bhcsv,bhcsk->bhcvk', w_loc, vc, kc)
    n_loc = jnp.einsum('bhcs,bhcsk->bhck', w_loc, kc)

    def step(carry, inp):
        C, n, m = carry
        g_c, m_c, C_c, n_c = inp
        m_new = jnp.maximum(g_c + m, m_c)
        s_old = jnp.exp(g_c + m - m_new)
        s_loc = jnp.exp(m_c - m_new)
        C_new = s_old[..., None, None] * C + s_loc[..., None, None] * C_c
        n_new = s_old[..., None] * n + s_loc[..., None] * n_c
        return (C_new, n_new, m_new), (C, n, m)

    init = (jnp.zeros((B, H, dv, dqk), f32), jnp.zeros((B, H, dqk), f32),
            jnp.full((B, H), NEG, f32))
    xs = (jnp.moveaxis(g, 2, 0), jnp.moveaxis(m_loc, 2, 0),
          jnp.moveaxis(C_loc, 2, 0), jnp.moveaxis(n_loc, 2, 0))
    _, (C_prev, n_prev, m_prev) = lax.scan(step, init, xs)
    C_prev = jnp.moveaxis(C_prev, 0, 2)
    n_prev = jnp.moveaxis(n_prev, 0, 2)
    m_prev = jnp.moveaxis(m_prev, 0, 2)

    causal = jnp.tril(jnp.ones((L, L), dtype=bool))
    D = b[..., :, None] - b[..., None, :] + log_i[..., None, :]
    D = jnp.where(causal, D, NEG)
    inter_log = b + m_prev[..., None]
    m_t = jnp.maximum(inter_log, jnp.max(D, axis=-1))
    W = jnp.exp(D - m_t[..., None]) * jnp.einsum('bhctk,bhcsk->bhcts', qc, kc)
    s_inter = jnp.exp(inter_log - m_t)
    num = (jnp.einsum('bhcts,bhcsv->bhctv', W, vc)
           + s_inter[..., None] * jnp.einsum('bhcvk,bhctk->bhctv', C_prev, qc))
    den = W.sum(-1) + s_inter * jnp.einsum('bhck,bhctk->bhct', n_prev, qc)
    h = num / jnp.maximum(jnp.abs(den), jnp.exp(-m_t))[..., None]
    return h.reshape(B, H, S, dv).astype(v.dtype)


def diff_attention(q, k, v, lam):
    B, H, _, S, d = q.shape
    dv = v.shape[-1]
    nqb = S // Q_BLOCK
    scale = d ** -0.5
    k_chunk = jnp.arange(S) // CHUNK
    vf = v.astype(jnp.float32)
    qb = jnp.moveaxis(q.reshape(B, H, 2, nqb, Q_BLOCK, d), 3, 0)

    def block(args):
        q_blk, blk = args
        s = jnp.einsum('bhcqd,bhckd->bhcqk', q_blk, k).astype(jnp.float32) * scale
        q_chunk = (blk * Q_BLOCK + jnp.arange(Q_BLOCK)) // CHUNK
        mask = k_chunk[None, :] <= q_chunk[:, None]
        p = jax.nn.softmax(jnp.where(mask, s, NEG), axis=-1)
        attn = p[:, :, 0] - lam * p[:, :, 1]
        return jnp.einsum('bhqk,bhkv->bhqv', attn, vf)

    out = lax.map(block, (qb, jnp.arange(nqb)))
    return jnp.moveaxis(out, 0, 2).reshape(B, H, S, dv).astype(v.dtype)


def mixer(h, layer_idx, w_in, conv_w, conv_b, i_bias, f_bias, m_norm_w, q_norm_w, k_norm_w,
          lambda_q1, lambda_k1, lambda_q2, lambda_k2, a_norm_w, w_out):
    B, S, _ = h.shape
    f32 = jnp.float32
    split_idx = np.cumsum(IN_SIZES)[:-1].tolist()
    proj = h @ w_in
    m_qk, m_v, m_o, m_i, m_f, a_q, a_k, a_v = jnp.split(proj, split_idx, axis=-1)

    def heads(t, d):
        return t.reshape(B, S, -1, d).transpose(0, 2, 1, 3)

    m_qk = jax.nn.silu(causal_dwconv(m_qk, conv_w, conv_b))
    m_q, m_k = jnp.split(m_qk, 2, axis=-1)
    m_q = heads(m_q, M_DQK)
    m_k = heads(m_k, M_DQK) * (M_DQK ** -0.5)
    m_v = heads(m_v, M_DV)
    i_pre = (m_i.astype(f32) + i_bias.astype(f32)).transpose(0, 2, 1)
    f_pre = (m_f.astype(f32) + f_bias.astype(f32)).transpose(0, 2, 1)
    hm = mlstm_chunkwise(m_q, m_k, m_v, i_pre, f_pre)
    hm = rms_norm(hm.transpose(0, 2, 1, 3), m_norm_w).reshape(B, S, -1) * jax.nn.sigmoid(m_o)

    a_q = rms_norm(a_q.reshape(B, S, A_HEADS, 2, A_DQK), q_norm_w).transpose(0, 2, 3, 1, 4)
    a_k = rms_norm(a_k.reshape(B, S, A_HEADS, 2, A_DQK), k_norm_w).transpose(0, 2, 3, 1, 4)
    a_v = heads(a_v, A_DV)
    lam_init = 0.8 - 0.6 * math.exp(-0.3 * layer_idx)
    lam = (jnp.exp(jnp.sum(lambda_q1.astype(f32) * lambda_k1.astype(f32)))
           - jnp.exp(jnp.sum(lambda_q2.astype(f32) * lambda_k2.astype(f32))) + lam_init)
    ha = diff_attention(a_q, a_k, a_v, lam)
    ha = (rms_norm(ha.transpose(0, 2, 1, 3), a_norm_w) * (1.0 - lam_init)).reshape(B, S, -1)

    return jnp.concatenate([hm, ha.astype(hm.dtype)], axis=-1) @ w_out


def swiglu(h, w_gate, w_up, w_down):
    return (jax.nn.silu(h @ w_gate) * (h @ w_up)) @ w_down


def setup_inputs(seed: int = 0) -> dict:
    key = jax.random.key(seed)
    ks = jax.random.split(key, 20)
    f32 = jnp.float32

    def nrm(k, shape, scale):
        return jax.random.normal(k, shape, f32) * scale

    return {
        'x': nrm(ks[0], (BATCH, SEQ, D_MODEL), 1.0),
        'norm1_w': 1.0 + nrm(ks[1], (DEPTH, D_MODEL), 0.02),
        'w_in': nrm(ks[2], (DEPTH, D_MODEL, N_IN), D_MODEL ** -0.5),
        'conv_w': nrm(ks[3], (DEPTH, CONV_W, M_QK), CONV_W ** -0.5),
        'conv_b': nrm(ks[4], (DEPTH, M_QK), 0.02),
        'i_bias': nrm(ks[5], (DEPTH, M_HEADS), 0.1),
        'f_bias': jnp.linspace(3.0, 6.0, M_HEADS, dtype=f32)[None, :] + nrm(ks[6], (DEPTH, M_HEADS), 0.1),
        'm_norm_w': 1.0 + nrm(ks[7], (DEPTH, M_HEADS, M_DV), 0.02),
        'q_norm_w': 1.0 + nrm(ks[8], (DEPTH, A_DQK), 0.02),
        'k_norm_w': 1.0 + nrm(ks[9], (DEPTH, A_DQK), 0.02),
        'lambda_q1': nrm(ks[10], (DEPTH, A_DQK), 0.1),
        'lambda_k1': nrm(ks[11], (DEPTH, A_DQK), 0.1),
        'lambda_q2': nrm(ks[12], (DEPTH, A_DQK), 0.1),
        'lambda_k2': nrm(ks[13], (DEPTH, A_DQK), 0.1),
        'a_norm_w': 1.0 + nrm(ks[14], (DEPTH, A_HEADS, A_DV), 0.02),
        'w_out': nrm(ks[15], (DEPTH, D_MIX, D_MODEL), D_MIX ** -0.5),
        'norm2_w': 1.0 + nrm(ks[16], (DEPTH, D_MODEL), 0.02),
        'w_gate': nrm(ks[17], (DEPTH, D_MODEL, D_FF), D_MODEL ** -0.5),
        'w_up': nrm(ks[18], (DEPTH, D_MODEL, D_FF), D_MODEL ** -0.5),
        'w_down': nrm(ks[19], (DEPTH, D_FF, D_MODEL), D_FF ** -0.5),
    }


def reference(x, norm1_w, w_in, conv_w, conv_b, i_bias, f_bias, m_norm_w, q_norm_w, k_norm_w,
              lambda_q1, lambda_k1, lambda_q2, lambda_k2, a_norm_w, w_out, norm2_w,
              w_gate, w_up, w_down):
    for l in range(DEPTH):
        h = rms_norm(x, norm1_w[l])
        x = x + mixer(h, l, w_in[l], conv_w[l], conv_b[l], i_bias[l], f_bias[l], m_norm_w[l],
                      q_norm_w[l], k_norm_w[l], lambda_q1[l], lambda_k1[l], lambda_q2[l],
                      lambda_k2[l], a_norm_w[l], w_out[l])
        h = rms_norm(x, norm2_w[l])
        x = x + swiglu(h, w_gate[l], w_up[l], w_down[l])
    return x
```

```cpp
#include <hip/hip_runtime.h>
#include <hip/hip_cooperative_groups.h>
#include <cstdio>
#include <cstdint>
namespace cg = cooperative_groups;

#define LAS __attribute__((address_space(3)))
typedef unsigned short bf16_t;
typedef short bf16x8 __attribute__((ext_vector_type(8)));
typedef float f32x4 __attribute__((ext_vector_type(4)));
typedef float f32x2 __attribute__((ext_vector_type(2)));
typedef float f32x16 __attribute__((ext_vector_type(16)));
typedef unsigned u32x4 __attribute__((ext_vector_type(4)));
typedef unsigned u32x2 __attribute__((ext_vector_type(2)));
typedef __bf16 bf16x2_t __attribute__((ext_vector_type(2)));
typedef LAS unsigned char* lptr;

constexpr int S = 8192, D = 2048, NIN = 6152, NP = 6144, DFF = 5632, NGU = 2 * DFF;
constexpr int NCH = 128;
constexpr float EPS = 1e-6f;
constexpr float NEGF = -1e30f;
constexpr float LOG2E = 1.4426950408889634f;
constexpr int C_MQK = 0, C_MV = 1024, C_MO = 2048, C_AQ = 3072, C_AK = 4096, C_AV = 5120;

constexpr size_t MiB = 1u << 20;
constexpr size_t WS_WIN = 0;
constexpr size_t WS_Y = 0;
constexpr size_t WS_WOUT = 32 * MiB;
constexpr size_t WS_WGU = 40 * MiB;
constexpr size_t WS_WD = 84 * MiB;
constexpr size_t WS_H1 = 106 * MiB;
constexpr size_t WS_PROJ = 138 * MiB;
constexpr size_t WS_VT = 234 * MiB;
constexpr size_t WS_G = 250 * MiB;
constexpr size_t WS_NS = WS_G + 262144;
constexpr size_t WS_GC = WS_NS + 262144;
constexpr size_t WS_MC = WS_GC + 4096;
constexpr size_t WS_MP = WS_MC + 4096;
constexpr size_t WS_SS = WS_MP + 4096;
constexpr size_t WS_END = WS_SS + 32768;

constexpr int LDS_BYTES = 153600;
#ifndef PH_MASK
#define PH_MASK 0xFFF
#endif
#define PH(k) constexpr ((PH_MASK >> (k)) & 1)

struct Params { const float* in[20]; float* out; unsigned char* ws; };

__device__ __forceinline__ unsigned pk2(float lo, float hi) { f32x2 v = {lo, hi}; bf16x2_t b = __builtin_convertvector(v, bf16x2_t); return __builtin_bit_cast(unsigned, b); }
__device__ __forceinline__ bf16_t f2bf(float x) { return (bf16_t)(pk2(x, 0.f) & 0xffffu); }
__device__ __forceinline__ float bf2f(bf16_t b) { return __uint_as_float(((unsigned)b) << 16); }
__device__ __forceinline__ float bflo(unsigned w) { return __uint_as_float(w << 16); }
__device__ __forceinline__ float bfhi(unsigned w) { return __uint_as_float(w & 0xffff0000u); }
__device__ __forceinline__ float sigmoidf_(float x) { return 1.f / (1.f + __expf(-x)); }
__device__ __forceinline__ float wave_sum(float v) {
#pragma unroll
    for (int o = 1; o < 64; o <<= 1) v += __shfl_xor(v, o);
    return v;
}
__device__ __forceinline__ float wave_max(float v) {
#pragma unroll
    for (int o = 1; o < 64; o <<= 1) v = fmaxf(v, __shfl_xor(v, o));
    return v;
}
__device__ __forceinline__ float wave_incl_sum(float v, int lane) {
#pragma unroll
    for (int o = 1; o < 64; o <<= 1) { float t = __shfl_up(v, o); if (lane >= o) v += t; }
    return v;
}
__device__ __forceinline__ float wave_incl_max(float v, int lane) {
#pragma unroll
    for (int o = 1; o < 64; o <<= 1) { float t = __shfl_up(v, o); if (lane >= o) v = fmaxf(v, t); }
    return v;
}
#define LDS_WAIT() asm volatile("s_waitcnt lgkmcnt(0)" ::: "memory")
#define MFMA16(a, b, c) __builtin_amdgcn_mfma_f32_16x16x32_bf16((a), (b), (c), 0, 0, 0)
#define MFMA32(a, b, c) __builtin_amdgcn_mfma_f32_32x32x16_bf16((a), (b), (c), 0, 0, 0)
__device__ __forceinline__ bf16x8 ldsfrag(lptr p) { return *(const LAS bf16x8*)p; }

namespace pg8 {
constexpr int BM = 256, BK = 64, HALF = 128, HTB = HALF * BK * 2, STAGE_BYTES = 8 * HTB, NXCD = 8, WGM = 8;
__device__ __forceinline__ int lds_byte(int r, int c) { const int st = (r >> 4) * 2 + (c >> 5), rr = r & 15, cc = c & 31, ob = rr * 64 + cc * 2; return st * 1024 + (ob ^ (((ob >> 9) & 1) << 5)); }
__device__ __forceinline__ void stage_rc(int b, int& R, int& C) { const int st = b / 1024, sb = b % 1024, swz = sb ^ (((sb >> 9) & 1) << 5); R = (st >> 1) * 16 + swz / 64; C = (st & 1) * 32 + (swz % 64) / 2; }
__device__ __forceinline__ int perm32(int rho) { const int n = rho >> 4, i = rho & 15; return 8 * (i >> 2) + 4 * n + (i & 3); }
struct Unit { int pm, pn; };
struct Gemm { const bf16_t* A; const bf16_t* Bt; int M, N, K; };
struct StaticOrder {
    int nM, nN, nwg, G, c;
    __device__ void init(int M, int N, int G_, int c_) { nM = M / BM; nN = N / BM; nwg = nM * nN; G = G_; c = c_; }
    __device__ bool next(int i, Unit& u) const {
        const long L = (long)i * G + c; if (L >= nwg) return false;
        int wgid = (int)L; { const int q = nwg / NXCD, r = nwg % NXCD, xcd = wgid % NXCD, off = wgid / NXCD; wgid = (xcd < r ? xcd * (q + 1) : r * (q + 1) + (xcd - r) * q) + off; }
        const int nig = WGM * nN, gid = wgid / nig, fm = gid * WGM, gsz = (nM - fm) < WGM ? (nM - fm) : WGM;
        u.pm = fm + ((wgid % nig) % gsz); u.pn = (wgid % nig) / gsz; return true;
    }
};

struct EpiStoreBf16 {
    static constexpr bool PERM = true;
    bf16_t* O; int ldc;
    __device__ __forceinline__ void operator()(const f32x4 (&acc)[2][2][4][2], const Unit& u, int wr, int wc, int fr, int fq) const {
        const int row0 = u.pm * BM + wr * 64 + fr, col0 = u.pn * BM + wc * 32 + 8 * fq;
#pragma unroll
        for (int ai = 0; ai < 2; ++ai)
#pragma unroll
            for (int m = 0; m < 4; ++m) { bf16_t* rowp = O + (size_t)(row0 + ai * HALF + m * 16) * ldc + col0;
#pragma unroll
                for (int bj = 0; bj < 2; ++bj) { const f32x4 v0 = acc[ai][bj][m][0], v1 = acc[ai][bj][m][1];
                    u32x4 w; w.x = pk2(v0[0], v0[1]); w.y = pk2(v0[2], v0[3]); w.z = pk2(v1[0], v1[1]); w.w = pk2(v1[2], v1[3]);
                    *(u32x4*)(rowp + bj * HALF) = w; } }
    }
};
struct EpiSwiGLU {
    static constexpr bool PERM = true;
    bf16_t* O; const float* ss;
    __device__ __forceinline__ void operator()(const f32x4 (&acc)[2][2][4][2], const Unit& u, int wr, int wc, int fr, int fq) const {
        const int row0 = u.pm * BM + wr * 64 + fr, col0 = u.pn * HALF + wc * 32 + 8 * fq;
#pragma unroll
        for (int ai = 0; ai < 2; ++ai)
#pragma unroll
            for (int m = 0; m < 4; ++m) { const int row = row0 + ai * HALF + m * 16;
                const float rs = rsqrtf(ss[row] * (1.0f / D) + EPS);
                float o[8];
#pragma unroll
                for (int n = 0; n < 2; ++n)
#pragma unroll
                    for (int e = 0; e < 4; ++e) { const float g = acc[ai][0][m][n][e] * rs, up = acc[ai][1][m][n][e] * rs; o[n * 4 + e] = g * sigmoidf_(g) * up; }
                u32x4 w; w.x = pk2(o[0], o[1]); w.y = pk2(o[2], o[3]); w.z = pk2(o[4], o[5]); w.w = pk2(o[6], o[7]);
                *(u32x4*)(O + (size_t)row * DFF + col0) = w; }
    }
};
struct EpiOutProj {
    static constexpr bool PERM = false;
    const float* x; float* out; bf16_t* xn; const float* g2; float* ss;
    __device__ __forceinline__ void operator()(const f32x4 (&acc)[2][2][4][2], const Unit& u, int wr, int wc, int fr, int fq) const {
        const int row0 = u.pm * BM + wr * 64 + fr, col0 = u.pn * BM + wc * 32 + 4 * fq;
#pragma unroll
        for (int ai = 0; ai < 2; ++ai)
#pragma unroll
            for (int m = 0; m < 4; ++m) { const int row = row0 + ai * HALF + m * 16; const size_t off = (size_t)row * D + col0; float sq = 0.f;
#pragma unroll
                for (int bj = 0; bj < 2; ++bj)
#pragma unroll
                    for (int n = 0; n < 2; ++n) { const int co = bj * HALF + n * 16;
                        const f32x4 xv = *(const f32x4*)(x + off + co); const f32x4 gv = *(const f32x4*)(g2 + col0 + co);
                        const f32x4 x1 = xv + acc[ai][bj][m][n];
                        *(f32x4*)(out + off + co) = x1;
                        sq += (x1[0] * x1[0] + x1[1] * x1[1]) + (x1[2] * x1[2] + x1[3] * x1[3]);
                        u32x2 w; w.x = pk2(x1[0] * gv[0], x1[1] * gv[1]); w.y = pk2(x1[2] * gv[2], x1[3] * gv[3]);
                        *(u32x2*)(xn + off + co) = w; }
                sq += __shfl_xor(sq, 16); sq += __shfl_xor(sq, 32);
                if (fq == 0) atomicAdd(ss + row, sq); }
    }
};
struct EpiDown {
    static constexpr bool PERM = false;
    float* out;
    __device__ __forceinline__ void operator()(const f32x4 (&acc)[2][2][4][2], const Unit& u, int wr, int wc, int fr, int fq) const {
        const int row0 = u.pm * BM + wr * 64 + fr, col0 = u.pn * BM + wc * 32 + 4 * fq;
#pragma unroll
        for (int ai = 0; ai < 2; ++ai)
#pragma unroll
            for (int m = 0; m < 4; ++m) { const size_t off = (size_t)(row0 + ai * HALF + m * 16) * D + col0;
#pragma unroll
                for (int bj = 0; bj < 2; ++bj)
#pragma unroll
                    for (int n = 0; n < 2; ++n) { const int co = bj * HALF + n * 16;
                        const f32x4 xv = *(const f32x4*)(out + off + co);
                        *(f32x4*)(out + off + co) = xv + acc[ai][bj][m][n]; } }
    }
};

template <class Epi, bool ALIGN_EPI>
__device__ __forceinline__ void gemm_phase(lptr lds, const Gemm g, const StaticOrder& S, const Epi& E) {
    int tid = threadIdx.x; asm volatile("" : "+v"(tid));
    const int wid = __builtin_amdgcn_readfirstlane(tid >> 6), lane = tid & 63, wr = wid >> 2, wc = wid & 3, fr = lane & 15, fq = lane >> 4;
    const int K = g.K, nt = K / BK;
    unsigned voffA[2], voffB[2];
#pragma unroll
    for (int i = 0; i < 2; ++i) { int R, C; stage_rc(tid * 16 + i * 8192, R, C); const int Rb = Epi::PERM ? ((R & ~31) + perm32(R & 31)) : R;
        voffA[i] = (unsigned)(R * K + C) * 2u; voffB[i] = (unsigned)(Rb * K + C) * 2u; }
    const size_t kstep = (size_t)(BK * 2);
    const size_t hstep = (size_t)HALF * K * 2;
    const size_t tstep = 2 * hstep;
    const unsigned ldsw = (unsigned)wid * 1024u;
    const int aoff = lds_byte(wr * 64 + fr, fq * 8), boff = lds_byte(wc * 32 + fr, fq * 8);
#define PG8_SA(b, h) (((b) * 2 + (h)) * HTB)
#define PG8_SB(b, h) ((4 + (b) * 2 + (h)) * HTB)
#define PG8_STAGE(bufoff, gbase, voff) do { _Pragma("unroll") for (int _i = 0; _i < 2; ++_i) \
        __builtin_amdgcn_global_load_lds((const unsigned*)((const char*)(gbase) + (voff)[_i]), (LAS unsigned*)(lds + (bufoff) + ldsw + _i * 8192), 16, 0, 0); } while (0)
#define PG8_LDA(dst, b, h) do { _Pragma("unroll") for (int m = 0; m < 4; ++m) _Pragma("unroll") for (int k = 0; k < 2; ++k) dst[m][k] = *(const LAS bf16x8*)(lds + PG8_SA(b, h) + aoff + m * 2048 + k * 1024); } while (0)
#define PG8_LDB(dst, b, h) do { _Pragma("unroll") for (int n = 0; n < 2; ++n) _Pragma("unroll") for (int k = 0; k < 2; ++k) dst[n][k] = *(const LAS bf16x8*)(lds + PG8_SB(b, h) + boff + n * 2048 + k * 1024); } while (0)
#define PG8_MMA(ai, bj, At, Bt) do { __builtin_amdgcn_s_setprio(1); _Pragma("unroll") for (int m = 0; m < 4; ++m) _Pragma("unroll") for (int n = 0; n < 2; ++n) _Pragma("unroll") for (int k = 0; k < 2; ++k) \
        acc[ai][bj][m][n] = __builtin_amdgcn_mfma_f32_16x16x32_bf16(Bt[n][k], At[m][k], acc[ai][bj][m][n], 0, 0, 0); __builtin_amdgcn_s_setprio(0); } while (0)
#define PG8_WAIT_V(n) asm volatile("s_waitcnt vmcnt(" #n ")" ::: "memory")
#define PG8_WAIT_L(n) asm volatile("s_waitcnt lgkmcnt(" #n ")" ::: "memory")
#define PG8_BAR __builtin_amdgcn_s_barrier()
#define PG8_SCHED __builtin_amdgcn_sched_barrier(0)
    Unit cur, nxt; int ui = 0;
    if (!S.next(0, cur)) return;
    f32x4 acc[2][2][4][2];
#pragma unroll
    for (int a = 0; a < 2; ++a)
#pragma unroll
        for (int b = 0; b < 2; ++b)
#pragma unroll
            for (int m = 0; m < 4; ++m)
#pragma unroll
                for (int n = 0; n < 2; ++n) acc[a][b][m][n] = (f32x4){0.f, 0.f, 0.f, 0.f};
    bf16x8 At[4][2], B0[2][2], B1[2][2];
    const char* cA = (const char*)g.A + (size_t)cur.pm * tstep; const char* cB = (const char*)g.Bt + (size_t)cur.pn * tstep;
    PG8_STAGE(PG8_SB(0, 0), cB, voffB); PG8_STAGE(PG8_SB(0, 1), cB + hstep, voffB); PG8_STAGE(PG8_SA(0, 0), cA, voffA); PG8_STAGE(PG8_SA(0, 1), cA + hstep, voffA);
    if (wr == 1) PG8_BAR;
    PG8_WAIT_V(2); PG8_BAR;
    PG8_STAGE(PG8_SB(1, 0), cB + kstep, voffB); PG8_STAGE(PG8_SA(1, 0), cA + kstep, voffA); PG8_STAGE(PG8_SB(1, 1), cB + hstep + kstep, voffB);
    PG8_WAIT_V(6); PG8_BAR;
    for (;;) {
        const bool has_next = S.next(ui + 1, nxt);
        const char* nA = has_next ? (const char*)g.A + (size_t)nxt.pm * tstep : cA; const char* nB = has_next ? (const char*)g.Bt + (size_t)nxt.pn * tstep : cB;
        for (int t = 0; t < nt; t += 2) {
            const bool last = (t == nt - 2);
            const char* a1 = cA + (size_t)(t + 1) * kstep;
            const char* a2 = last ? nA : cA + (size_t)(t + 2) * kstep; const char* b2 = last ? nB : cB + (size_t)(t + 2) * kstep;
            const char* a3 = a2 + kstep; const char* b3 = b2 + kstep;
            PG8_LDB(B0, 0, 0); PG8_LDB(B1, 0, 1); PG8_SCHED; PG8_LDA(At, 0, 0); PG8_STAGE(PG8_SA(1, 1), a1 + hstep, voffA);
            PG8_WAIT_V(8); PG8_WAIT_L(0); PG8_BAR; PG8_MMA(0, 0, At, B0); PG8_MMA(0, 1, At, B1); PG8_BAR; PG8_SCHED;
            PG8_LDA(At, 0, 1); PG8_STAGE(PG8_SB(0, 0), b2, voffB); PG8_STAGE(PG8_SB(0, 1), b2 + hstep, voffB); PG8_STAGE(PG8_SA(0, 0), a2, voffA);
            PG8_WAIT_V(8); PG8_WAIT_L(0); PG8_BAR; PG8_MMA(1, 0, At, B0); PG8_MMA(1, 1, At, B1); PG8_BAR; PG8_SCHED;
            PG8_LDB(B0, 1, 0); PG8_LDB(B1, 1, 1); PG8_SCHED; PG8_LDA(At, 1, 0); PG8_STAGE(PG8_SA(0, 1), a2 + hstep, voffA);
            PG8_WAIT_V(8); PG8_WAIT_L(0); PG8_BAR; PG8_MMA(0, 0, At, B0); PG8_MMA(0, 1, At, B1); PG8_BAR; PG8_SCHED;
            PG8_LDA(At, 1, 1); PG8_STAGE(PG8_SB(1, 0), b3, voffB); PG8_STAGE(PG8_SB(1, 1), b3 + hstep, voffB); PG8_STAGE(PG8_SA(1, 0), a3, voffA);
            PG8_WAIT_V(8); PG8_WAIT_L(0); PG8_BAR; PG8_MMA(1, 0, At, B0); PG8_MMA(1, 1, At, B1); PG8_BAR; PG8_SCHED;
        }
        if constexpr (ALIGN_EPI) { if (wr == 0) PG8_BAR; }
        E(acc, cur, wr, wc, fr, fq);
        if (!has_next) break;
#pragma unroll
        for (int a = 0; a < 2; ++a)
#pragma unroll
            for (int b = 0; b < 2; ++b)
#pragma unroll
                for (int m = 0; m < 4; ++m)
#pragma unroll
                    for (int n = 0; n < 2; ++n) acc[a][b][m][n] = (f32x4){0.f, 0.f, 0.f, 0.f};
        cur = nxt; cA = nA; cB = nB; ++ui;
        if constexpr (ALIGN_EPI) { if (wr == 1) PG8_BAR; }
    }
    PG8_WAIT_V(0);
    if constexpr (!ALIGN_EPI) { if (wr == 0) PG8_BAR; }
    PG8_BAR;
#undef PG8_SA
#undef PG8_SB
#undef PG8_STAGE
#undef PG8_LDA
#undef PG8_LDB
#undef PG8_MMA
#undef PG8_WAIT_V
#undef PG8_WAIT_L
#undef PG8_BAR
#undef PG8_SCHED
}
}

__device__ __forceinline__ void transpose_item(const float* W, int ldw, int col0, int k0, bf16_t* WT, int K, int row0, LAS float* scr, int lane) {
#pragma unroll 8
    for (int i = 0; i < 32; ++i) { const int kk = 2 * i + (lane >> 5); scr[kk * 33 + (lane & 31)] = W[(size_t)(k0 + kk) * ldw + col0 + (lane & 31)]; }
    LDS_WAIT();
    const int c = lane & 7;
#pragma unroll
    for (int j = 0; j < 4; ++j) { const int n = (lane >> 3) + 8 * j; const LAS float* s = scr + (8 * c) * 33 + n;
        u32x4 o; o.x = pk2(s[0 * 33], s[1 * 33]); o.y = pk2(s[2 * 33], s[3 * 33]); o.z = pk2(s[4 * 33], s[5 * 33]); o.w = pk2(s[6 * 33], s[7 * 33]);
        *(u32x4*)(WT + (size_t)(row0 + n) * K + k0 + 8 * c) = o; }
    LDS_WAIT();
}

__device__ __forceinline__ void p0_prologue(const Params& p, lptr lds, int tid, int G) {
    const int lane = tid & 63, wid = tid >> 6;
    const int gw = blockIdx.x * 8 + wid, NGW = G * 8;
    unsigned char* ws = p.ws;
    { float* ss = (float*)(ws + WS_SS); for (int i = blockIdx.x * 512 + tid; i < S; i += G * 512) ss[i] = 0.f; }
    LAS float* WGs = (LAS float*)(lds + 69632);
    { const float* w_in = p.in[2];
      for (int idx = tid; idx < 4096; idx += 512) { const int k = idx >> 1, half = idx & 1;
          const f32x4 v = *(const f32x4*)(w_in + (size_t)k * NIN + 3072 + half * 4);
          const int slot = ((k >> 8) * 4 + (k & 3)) * 64 + ((k >> 2) & 63);
          *(LAS f32x4*)(WGs + slot * 8 + half * 4) = v; } }
    LAS float* scr = (LAS float*)(lds + wid * 8448);
    constexpr int I_IN = 32 * 192, I_OUT = 32 * 64, I_G = 32 * 176, I_D = 88 * 64;
    constexpr int NITEMS = I_IN + I_OUT + 2 * I_G + I_D;
    for (int it = gw; it < NITEMS; it += NGW) {
        int r = it;
        if (r < I_IN) { const int kb = r / 192, n0 = (r % 192) * 32; transpose_item(p.in[2], NIN, n0 + (n0 >= 3072 ? 8 : 0), kb * 64, (bf16_t*)(ws + WS_WIN), D, n0, scr, lane); continue; } r -= I_IN;
        if (r < I_OUT) { const int kb = r / 64, n0 = (r % 64) * 32; transpose_item(p.in[15], D, n0, kb * 64, (bf16_t*)(ws + WS_WOUT), D, n0, scr, lane); continue; } r -= I_OUT;
        if (r < I_G) { const int kb = r / 176, n0 = (r % 176) * 32; transpose_item(p.in[17], DFF, n0, kb * 64, (bf16_t*)(ws + WS_WGU), D, (n0 >> 7) * 256 + (n0 & 127), scr, lane); continue; } r -= I_G;
        if (r < I_G) { const int kb = r / 176, n0 = (r % 176) * 32; transpose_item(p.in[18], DFF, n0, kb * 64, (bf16_t*)(ws + WS_WGU), D, (n0 >> 7) * 256 + 128 + (n0 & 127), scr, lane); continue; } r -= I_G;
        { const int kb = r / 64, n0 = (r % 64) * 32; transpose_item(p.in[19], D, n0, kb * 64, (bf16_t*)(ws + WS_WD), DFF, n0, scr, lane); }
    }
    __syncthreads();
    const float* x = p.in[0]; const float* g1 = p.in[1]; bf16_t* H1 = (bf16_t*)(ws + WS_H1); float* Gt = (float*)(ws + WS_G);
    for (int m = gw; m < S; m += NGW) {
        float ssq = 0.f;
#pragma unroll
        for (int j = 0; j < 8; ++j) { const f32x4 v = *(const f32x4*)(x + (size_t)m * D + 256 * j + 4 * lane); ssq += (v[0] * v[0] + v[1] * v[1]) + (v[2] * v[2] + v[3] * v[3]); }
        const float rstd = rsqrtf(wave_sum(ssq) * (1.0f / D) + EPS);
        float ga[8];
#pragma unroll
        for (int q = 0; q < 8; ++q) ga[q] = 0.f;
#pragma unroll 1
        for (int j = 0; j < 8; ++j) { const f32x4 gv = *(const f32x4*)(g1 + 256 * j + 4 * lane);
            const f32x4 xv = *(const f32x4*)(x + (size_t)m * D + 256 * j + 4 * lane);
            f32x4 hv = xv * rstd * gv;
            u32x2 w; w.x = pk2(hv[0], hv[1]); w.y = pk2(hv[2], hv[3]);
            *(u32x2*)(H1 + (size_t)m * D + 256 * j + 4 * lane) = w;
#pragma unroll
            for (int e = 0; e < 4; ++e) { const LAS float* wp = WGs + ((j * 4 + e) * 64 + lane) * 8; const f32x4 w0 = *(const LAS f32x4*)wp, w1 = *(const LAS f32x4*)(wp + 4);
                ga[0] += hv[e] * w0[0]; ga[1] += hv[e] * w0[1]; ga[2] += hv[e] * w0[2]; ga[3] += hv[e] * w0[3];
                ga[4] += hv[e] * w1[0]; ga[5] += hv[e] * w1[1]; ga[6] += hv[e] * w1[2]; ga[7] += hv[e] * w1[3]; } }
#pragma unroll
        for (int q = 0; q < 8; ++q) ga[q] = wave_sum(ga[q]);
        if (lane == 0) { *(f32x4*)(Gt + (size_t)m * 8) = (f32x4){ga[0], ga[1], ga[2], ga[3]}; *(f32x4*)(Gt + (size_t)m * 8 + 4) = (f32x4){ga[4], ga[5], ga[6], ga[7]}; }
    }
    __syncthreads();
}

__device__ __forceinline__ float log_sigmoid_(float f) { return fminf(f, 0.f) - log1pf(__expf(-fabsf(f))); }

__device__ __forceinline__ void p2_m1_tile(const Params& p, lptr lds, int h, int c, int tid) {
    const int lane = tid & 63, wid = tid >> 6, fr = lane & 15, fq = lane >> 4;
    unsigned char* ws = p.ws;
    const bf16_t* PROJ = (const bf16_t*)(ws + WS_PROJ);
    const float* Gt = (const float*)(ws + WS_G);
    constexpr int KT_OFF = 0, VW_OFF = 18432, WL_OFF = 55296, TR_OFF = 55552;
    LAS float* wl = (LAS float*)(lds + WL_OFF);
    const int row0 = 64 * c;
    if (wid == 0) {
        const int row = row0 + lane;
        const float ip = Gt[(size_t)row * 8 + h] + p.in[5][h];
        const float fp = Gt[(size_t)row * 8 + 4 + h] + p.in[6][h];
        const float b = wave_incl_sum(log_sigmoid_(fp), lane);
        const float g = __shfl(b, 63);
        const float a = g - b + ip;
        const float ml = wave_max(a);
        wl[lane] = __expf(a - ml);
        if (lane == 0) { ((float*)(ws + WS_GC))[h * NCH + c] = g; ((float*)(ws + WS_MC))[h * NCH + c] = ml; }
    }
    {
        const int j = tid & 127, sg = tid >> 7, ch = 512 + h * 128 + j;
        const float w0 = p.in[3][ch], w1 = p.in[3][1024 + ch], w2 = p.in[3][2048 + ch], w3 = p.in[3][3072 + ch], cb = p.in[4][ch];
        const int r0 = row0 + 16 * sg;
        float xm3 = (r0 - 3 >= 0) ? bf2f(PROJ[(size_t)(r0 - 3) * NP + ch]) : 0.f;
        float xm2 = (r0 - 2 >= 0) ? bf2f(PROJ[(size_t)(r0 - 2) * NP + ch]) : 0.f;
        float xm1 = (r0 - 1 >= 0) ? bf2f(PROJ[(size_t)(r0 - 1) * NP + ch]) : 0.f;
#pragma unroll 4
        for (int i = 0; i < 16; ++i) { const float x0 = bf2f(PROJ[(size_t)(r0 + i) * NP + ch]);
            float y = w0 * xm3 + w1 * xm2 + w2 * xm1 + w3 * x0 + cb; y = y * sigmoidf_(y) * 0.08838834764831845f;
            *(LAS bf16_t*)(lds + KT_OFF + j * 144 + (16 * sg + i) * 2) = f2bf(y);
            xm3 = xm2; xm2 = xm1; xm1 = x0; }
    }
    {
#pragma unroll
        for (int i = 0; i < 4; ++i) { const int idx = tid + 512 * i, r = idx >> 5, ck = idx & 31;
            const u32x4 v = *(const u32x4*)(PROJ + (size_t)(row0 + r) * NP + C_AV + h * 256 + ck * 8);
            *(LAS u32x4*)(lds + TR_OFF + r * 528 + ck * 16) = v; }
    }
    __syncthreads();
    {
        const int v = tid & 255, sg = tid >> 8;
#pragma unroll 4
        for (int i = 0; i < 32; ++i) { const int s = 32 * sg + i; const float xv = bf2f(PROJ[(size_t)(row0 + s) * NP + C_MV + h * 256 + v]);
            *(LAS bf16_t*)(lds + VW_OFF + v * 144 + s * 2) = f2bf(xv * wl[s]); }
    }
    {
        bf16_t* VT = (bf16_t*)(ws + WS_VT);
#pragma unroll
        for (int i = 0; i < 4; ++i) { const int idx = tid + 512 * i, s0 = (idx & 7) * 8, dv = idx >> 3;
            unsigned short e[8];
#pragma unroll
            for (int q = 0; q < 8; ++q) e[q] = *(const LAS bf16_t*)(lds + TR_OFF + (s0 + q) * 528 + dv * 2);
            u32x4 o; o.x = e[0] | ((unsigned)e[1] << 16); o.y = e[2] | ((unsigned)e[3] << 16); o.z = e[4] | ((unsigned)e[5] << 16); o.w = e[6] | ((unsigned)e[7] << 16);
            *(u32x4*)(VT + ((size_t)(h * 256 + dv)) * S + row0 + s0) = o; }
    }
    __syncthreads();
    if (tid < 128) { float a = 0.f;
        for (int s = 0; s < 64; ++s) a += wl[s] * bf2f(*(const LAS bf16_t*)(lds + KT_OFF + tid * 144 + s * 2));
        ((float*)(ws + WS_NS))[(size_t)(h * NCH + c) * 128 + tid] = a; }
    {
        f32x4 acc[2][8];
#pragma unroll
        for (int mi = 0; mi < 2; ++mi)
#pragma unroll
            for (int ni = 0; ni < 8; ++ni) acc[mi][ni] = (f32x4){0.f, 0.f, 0.f, 0.f};
#pragma unroll
        for (int ks = 0; ks < 2; ++ks) {
            bf16x8 af[2];
#pragma unroll
            for (int mi = 0; mi < 2; ++mi) af[mi] = ldsfrag(lds + VW_OFF + (32 * wid + 16 * mi + fr) * 144 + ks * 64 + fq * 16);
#pragma unroll
            for (int ni = 0; ni < 8; ++ni) { const bf16x8 bfr = ldsfrag(lds + KT_OFF + (16 * ni + fr) * 144 + ks * 64 + fq * 16);
#pragma unroll
                for (int mi = 0; mi < 2; ++mi) acc[mi][ni] = MFMA16(bfr, af[mi], acc[mi][ni]); }
        }
        bf16_t* CS = (bf16_t*)(ws + WS_H1) + (size_t)(h * NCH + c) * 32768;
#pragma unroll
        for (int mi = 0; mi < 2; ++mi)
#pragma unroll
            for (int ni = 0; ni < 8; ++ni) { u32x2 w; w.x = pk2(acc[mi][ni][0], acc[mi][ni][1]); w.y = pk2(acc[mi][ni][2], acc[mi][ni][3]);
                *(u32x2*)(CS + (32 * wid + 16 * mi + fr) * 128 + 16 * ni + 4 * fq) = w; }
    }
    __syncthreads();
}

__device__ __forceinline__ void p2_qknorm(const Params& p, int job, int tid) {
    const int lane = tid & 63, wid = tid >> 6;
    bf16_t* PROJ = (bf16_t*)(p.ws + WS_PROJ);
    const float qs = 0.08838834764831845f * LOG2E;
    for (int i = 0; i < 8; ++i) {
        const int row = job * 64 + wid * 8 + i;
#pragma unroll
        for (int part = 0; part < 4; ++part) {
            bf16_t* ptr = PROJ + (size_t)row * NP + C_AQ + part * 512 + lane * 8;
            const u32x4 raw = *(const u32x4*)ptr;
            float v[8] = {bflo(raw.x), bfhi(raw.x), bflo(raw.y), bfhi(raw.y), bflo(raw.z), bfhi(raw.z), bflo(raw.w), bfhi(raw.w)};
            float sq = 0.f;
#pragma unroll
            for (int e = 0; e < 8; ++e) sq += v[e] * v[e];
            sq += __shfl_xor(sq, 1); sq += __shfl_xor(sq, 2); sq += __shfl_xor(sq, 4); sq += __shfl_xor(sq, 8);
            const float rs = rsqrtf(sq * (1.0f / 128.f) + EPS) * (part < 2 ? qs : 1.f);
            const float* nw = (part < 2 ? p.in[8] : p.in[9]) + (lane & 15) * 8;
            const f32x4 n0 = *(const f32x4*)nw, n1 = *(const f32x4*)(nw + 4);
            u32x4 o; o.x = pk2(v[0] * rs * n0[0], v[1] * rs * n0[1]); o.y = pk2(v[2] * rs * n0[2], v[3] * rs * n0[3]);
            o.z = pk2(v[4] * rs * n1[0], v[5] * rs * n1[1]); o.w = pk2(v[6] * rs * n1[2], v[7] * rs * n1[3]);
            *(u32x4*)ptr = o;
        }
    }
}

__device__ __forceinline__ void p3_scan(const Params& p, int job, int tid) {
    unsigned char* ws = p.ws;
    const float* GC = (const float*)(ws + WS_GC); const float* MC = (const float*)(ws + WS_MC);
    if (job < 128) {
        const int h = job >> 5, e2 = (job & 31) * 512 + tid;
        unsigned* ptr = (unsigned*)(ws + WS_H1) + (size_t)h * NCH * 16384 + e2;
        float c0 = 0.f, c1 = 0.f, m = NEGF;
        for (int c = 0; c < NCH; ++c) {
            const float g = GC[h * NCH + c], mc = MC[h * NCH + c];
            const unsigned loc = ptr[(size_t)c * 16384];
            ptr[(size_t)c * 16384] = pk2(c0, c1);
            const float mn = fmaxf(g + m, mc), so = __expf(g + m - mn), sl = __expf(mc - mn);
            c0 = so * c0 + sl * bflo(loc); c1 = so * c1 + sl * bfhi(loc); m = mn;
        }
    } else if (tid < 128) {
        const int h = job - 128;
        float* ns = (float*)(ws + WS_NS) + (size_t)h * NCH * 128 + tid; float* MP = (float*)(ws + WS_MP);
        float n = 0.f, m = NEGF;
        for (int c = 0; c < NCH; ++c) {
            const float g = GC[h * NCH + c], mc = MC[h * NCH + c];
            const float loc = ns[c * 128];
            ns[c * 128] = n; if (tid == 0) MP[h * NCH + c] = m;
            const float mn = fmaxf(g + m, mc), so = __expf(g + m - mn), sl = __expf(mc - mn);
            n = so * n + sl * loc; m = mn;
        }
    }
}

__device__ __forceinline__ void p4_m3_tile(const Params& p, lptr lds, int h, int c, int tid) {
    const int lane = tid & 63, wid = tid >> 6, fr = lane & 15, fq = lane >> 4;
    unsigned char* ws = p.ws;
    const bf16_t* PROJ = (const bf16_t*)(ws + WS_PROJ);
    const float* Gt = (const float*)(ws + WS_G);
    constexpr int QS = 0, KS = 17408, VTO = 34816, CP = 71680, WSO = 141312, SM = 150528;
    LAS float* sm = (LAS float*)(lds + SM);
    LAS float* sb = sm, *su = sm + 64, *sMx = sm + 128, *sint = sm + 192, *denp = sm + 256, *snq = sm + 384, *snp = sm + 448, *ssqp = sm + 576;
    const int row0 = 64 * c;
    { const u32x4* src = (const u32x4*)((const bf16_t*)(ws + WS_H1) + (size_t)(h * NCH + c) * 32768);
#pragma unroll
      for (int i = 0; i < 8; ++i) { const int idx = tid + 512 * i, v = idx >> 4, ck = idx & 15;
          *(LAS u32x4*)(lds + CP + v * 272 + ck * 16) = src[idx]; } }
    { const int c2 = tid & 255, sg = tid >> 8; const bool isk = c2 >= 128; const int j = c2 & 127, ch = (isk ? 512 : 0) + h * 128 + j;
      const float w0 = p.in[3][ch], w1 = p.in[3][1024 + ch], w2 = p.in[3][2048 + ch], w3 = p.in[3][3072 + ch], cb = p.in[4][ch];
      const float sc = isk ? 0.08838834764831845f : 1.f;
      const int r0 = row0 + 32 * sg; lptr dst = lds + (isk ? KS : QS) + j * 2;
      float xm3 = (r0 - 3 >= 0) ? bf2f(PROJ[(size_t)(r0 - 3) * NP + ch]) : 0.f;
      float xm2 = (r0 - 2 >= 0) ? bf2f(PROJ[(size_t)(r0 - 2) * NP + ch]) : 0.f;
      float xm1 = (r0 - 1 >= 0) ? bf2f(PROJ[(size_t)(r0 - 1) * NP + ch]) : 0.f;
#pragma unroll 4
      for (int i = 0; i < 32; ++i) { const float x0 = bf2f(PROJ[(size_t)(r0 + i) * NP + ch]);
          float y = w0 * xm3 + w1 * xm2 + w2 * xm1 + w3 * x0 + cb; y = y * sigmoidf_(y) * sc;
          *(LAS bf16_t*)(dst + (32 * sg + i) * 272) = f2bf(y);
          xm3 = xm2; xm2 = xm1; xm1 = x0; } }
    { const int v = tid & 255, sg = tid >> 8;
#pragma unroll 4
      for (int i = 0; i < 32; ++i) { const int s = 32 * sg + i;
          *(LAS bf16_t*)(lds + VTO + v * 144 + s * 2) = PROJ[(size_t)(row0 + s) * NP + C_MV + h * 256 + v]; } }
    if (tid < 128) snp[tid] = ((const float*)(ws + WS_NS))[(size_t)(h * NCH + c) * 128 + tid];
    if (wid == 7) {
        const int row = row0 + lane;
        const float ip = Gt[(size_t)row * 8 + h] + p.in[5][h];
        const float fp = Gt[(size_t)row * 8 + 4 + h] + p.in[6][h];
        const float b = wave_incl_sum(log_sigmoid_(fp), lane);
        const float u = ip - b;
        const float pm = wave_incl_max(u, lane);
        const float mprev = ((const float*)(ws + WS_MP))[h * NCH + c];
        const float Mx = fmaxf(mprev, pm);
        sb[lane] = b; su[lane] = u; sMx[lane] = Mx; sint[lane] = __expf(mprev - Mx);
    }
    __syncthreads();
    {
        const int mi = wid >> 1, n0 = 32 * (wid & 1);
        f32x4 a0 = {0.f, 0.f, 0.f, 0.f}, a1 = {0.f, 0.f, 0.f, 0.f};
#pragma unroll
        for (int ks = 0; ks < 4; ++ks) { const bf16x8 af = ldsfrag(lds + QS + (16 * mi + fr) * 272 + ks * 64 + fq * 16);
            const bf16x8 b0 = ldsfrag(lds + KS + (n0 + fr) * 272 + ks * 64 + fq * 16), b1 = ldsfrag(lds + KS + (n0 + 16 + fr) * 272 + ks * 64 + fq * 16);
            a0 = MFMA16(b0, af, a0); a1 = MFMA16(b1, af, a1); }
        const int t = 16 * mi + fr; const float Mt = sMx[t]; float rsum = 0.f; float w[8];
#pragma unroll
        for (int e = 0; e < 4; ++e) { const int s0 = n0 + 4 * fq + e, s1 = s0 + 16;
            w[e] = (s0 <= t) ? __expf(su[s0] - Mt) * a0[e] : 0.f; w[4 + e] = (s1 <= t) ? __expf(su[s1] - Mt) * a1[e] : 0.f; rsum += w[e] + w[4 + e]; }
        u32x2 o0, o1; o0.x = pk2(w[0], w[1]); o0.y = pk2(w[2], w[3]); o1.x = pk2(w[4], w[5]); o1.y = pk2(w[6], w[7]);
        *(LAS u32x2*)(lds + WSO + t * 144 + (n0 + 4 * fq) * 2) = o0; *(LAS u32x2*)(lds + WSO + t * 144 + (n0 + 16 + 4 * fq) * 2) = o1;
        rsum += __shfl_xor(rsum, 16); rsum += __shfl_xor(rsum, 32);
        if (fq == 0) denp[t * 2 + (wid & 1)] = rsum;
    }
    if (tid < 64) { float a = 0.f;
        for (int k = 0; k < 128; ++k) a += snp[k] * bf2f(*(const LAS bf16_t*)(lds + QS + tid * 272 + k * 2));
        snq[tid] = a; }
    __syncthreads();
    {
        const int mi = wid & 3, vh = wid >> 2, t = 16 * mi + fr;
        f32x4 acc[8];
#pragma unroll
        for (int ni = 0; ni < 8; ++ni) acc[ni] = (f32x4){0.f, 0.f, 0.f, 0.f};
#pragma unroll
        for (int ks = 0; ks < 4; ++ks) { const bf16x8 af = ldsfrag(lds + QS + t * 272 + ks * 64 + fq * 16);
#pragma unroll
            for (int ni = 0; ni < 8; ++ni) { const bf16x8 bfr = ldsfrag(lds + CP + (128 * vh + 16 * ni + fr) * 272 + ks * 64 + fq * 16); acc[ni] = MFMA16(bfr, af, acc[ni]); } }
        const float si = sint[t];
#pragma unroll
        for (int ni = 0; ni < 8; ++ni) acc[ni] = acc[ni] * si;
#pragma unroll
        for (int ks = 0; ks < 2; ++ks) { const bf16x8 af = ldsfrag(lds + WSO + t * 144 + ks * 64 + fq * 16);
#pragma unroll
            for (int ni = 0; ni < 8; ++ni) { const bf16x8 bfr = ldsfrag(lds + VTO + (128 * vh + 16 * ni + fr) * 144 + ks * 64 + fq * 16); acc[ni] = MFMA16(bfr, af, acc[ni]); } }
        const float den = denp[2 * t] + denp[2 * t + 1] + si * snq[t];
        const float mt = sb[t] + sMx[t];
        const float inv = 1.f / fmaxf(fabsf(den), __expf(-mt));
        float sq = 0.f;
#pragma unroll
        for (int ni = 0; ni < 8; ++ni) { acc[ni] = acc[ni] * inv; sq += (acc[ni][0] * acc[ni][0] + acc[ni][1] * acc[ni][1]) + (acc[ni][2] * acc[ni][2] + acc[ni][3] * acc[ni][3]); }
        sq += __shfl_xor(sq, 16); sq += __shfl_xor(sq, 32);
        if (fq == 0) ssqp[2 * t + vh] = sq;
        __syncthreads();
        const float rstd = rsqrtf((ssqp[2 * t] + ssqp[2 * t + 1]) * (1.0f / 256.f) + EPS);
        bf16_t* Y = (bf16_t*)(ws + WS_Y);
        const float* mnw = p.in[7] + h * 256;
#pragma unroll
        for (int ni = 0; ni < 8; ++ni) { const int v = 128 * vh + 16 * ni + 4 * fq;
            const u32x2 mo = *(const u32x2*)(PROJ + (size_t)(row0 + t) * NP + C_MO + h * 256 + v);
            const f32x4 nw = *(const f32x4*)(mnw + v);
            const float o0 = acc[ni][0] * rstd * nw[0] * sigmoidf_(bflo(mo.x)), o1 = acc[ni][1] * rstd * nw[1] * sigmoidf_(bfhi(mo.x));
            const float o2 = acc[ni][2] * rstd * nw[2] * sigmoidf_(bflo(mo.y)), o3 = acc[ni][3] * rstd * nw[3] * sigmoidf_(bfhi(mo.y));
            u32x2 w; w.x = pk2(o0, o1); w.y = pk2(o2, o3);
            *(u32x2*)(Y + (size_t)(row0 + t) * D + h * 256 + v) = w; }
    }
    __syncthreads();
}

__device__ __forceinline__ void p4_attn_unit(const Params& p, lptr lds, int h, int c, int tid) {
    const int lane = tid & 63, wid = __builtin_amdgcn_readfirstlane(tid >> 6), r = lane & 31, hh = lane >> 5;
    const int mp = wid & 1, qh = (wid >> 1) & 1, kh = wid >> 2;
    unsigned char* ws = p.ws;
    const bf16_t* PROJ = (const bf16_t*)(ws + WS_PROJ);
    const bf16_t* VTg = (const bf16_t*)(ws + WS_VT) + (size_t)h * 256 * S;
    constexpr int BUF = 71680, KC = 17408, VO = 34816;
    bf16x8 qf[8];
    { const bf16_t* qp = PROJ + (size_t)(64 * c + 32 * qh + r) * NP + C_AQ + h * 256 + mp * 128 + 8 * hh;
#pragma unroll
      for (int s = 0; s < 8; ++s) qf[s] = *(const bf16x8*)(qp + 16 * s); }
    f32x16 O[8];
#pragma unroll
    for (int u = 0; u < 8; ++u)
#pragma unroll
        for (int g = 0; g < 16; ++g) O[u][g] = 0.f;
    float lsum = 0.f;
    unsigned goff[9];
#pragma unroll
    for (int j = 0; j < 9; ++j) { const int I = wid + 8 * j, pos = I * 1024 + lane * 16;
        if (pos < VO) { const int comp = pos / KC, rp = pos % KC, row = rp / 272; int cb = rp % 272; if (cb >= 256) cb = 0;
            goff[j] = (unsigned)(row * NP + comp * 128 + (cb >> 1)); }
        else { const int rp = pos - VO, dv = rp / 144; int cb = rp % 144; if (cb >= 128) cb = 0;
            goff[j] = (unsigned)(dv * S + (cb >> 1)); } }
    const bf16_t* kbase = PROJ + C_AK + h * 256;
#define ATT_ISSUE(t, b) do { _Pragma("unroll") for (int j = 0; j < 9; ++j) { const int I = wid + 8 * j; if (I < 70) { \
        const bf16_t* src = (I < 34) ? (kbase + (size_t)(64 * (t)) * NP + goff[j]) : (VTg + 64 * (t) + goff[j]); \
        __builtin_amdgcn_global_load_lds((const unsigned*)src, (LAS unsigned*)(lds + (b) * BUF + I * 1024), 16, 0, 0); } } } while (0)
    ATT_ISSUE(0, 0);
    asm volatile("s_waitcnt vmcnt(0)" ::: "memory");
    __syncthreads();
    const int sig = (r & ~12) | ((r & 4) << 1) | ((r & 8) >> 1);
    const int koff = mp * KC + (32 * kh + sig) * 272 + hh * 16;
    const int voff = VO + r * 144 + (32 * kh + 8 * hh) * 2;
    for (int t = 0; t <= c; ++t) {
        const int b = t & 1;
        if (t < c) ATT_ISSUE(t + 1, b ^ 1);
        lptr base = lds + b * BUF;
        f32x16 sa;
#pragma unroll
        for (int g = 0; g < 16; ++g) sa[g] = 0.f;
#pragma unroll
        for (int s = 0; s < 8; ++s) { const bf16x8 a = ldsfrag(base + koff + s * 32); sa = MFMA32(a, qf[s], sa); }
        float ls = 0.f;
#pragma unroll
        for (int g = 0; g < 16; ++g) { sa[g] = __builtin_amdgcn_exp2f(sa[g]); ls += sa[g]; }
        lsum += ls;
        bf16x8 pb[2];
#pragma unroll
        for (int s2 = 0; s2 < 2; ++s2) { u32x4 w; w.x = pk2(sa[8 * s2], sa[8 * s2 + 1]); w.y = pk2(sa[8 * s2 + 2], sa[8 * s2 + 3]); w.z = pk2(sa[8 * s2 + 4], sa[8 * s2 + 5]); w.w = pk2(sa[8 * s2 + 6], sa[8 * s2 + 7]);
            pb[s2] = __builtin_bit_cast(bf16x8, w); }
#pragma unroll
        for (int u = 0; u < 8; ++u)
#pragma unroll
            for (int s2 = 0; s2 < 2; ++s2) { const bf16x8 a = ldsfrag(base + voff + u * 32 * 144 + s2 * 32); O[u] = MFMA32(a, pb[s2], O[u]); }
        asm volatile("s_waitcnt vmcnt(0)" ::: "memory");
        __syncthreads();
    }
#undef ATT_ISSUE
    LAS float* Of = (LAS float*)lds; LAS float* Lf = (LAS float*)(lds + 133120);
    const float lt = lsum + __shfl_xor(lsum, 32);
    const int qrow = mp * 64 + 32 * qh + r;
    if (kh == 0) {
#pragma unroll
        for (int u = 0; u < 8; ++u)
#pragma unroll
            for (int g = 0; g < 16; ++g) Of[qrow * 260 + 32 * u + (g & 3) + 8 * (g >> 2) + 4 * hh] = O[u][g];
        if (hh == 0) Lf[qrow] = lt;
    }
    __syncthreads();
    if (kh == 1) {
#pragma unroll
        for (int u = 0; u < 8; ++u)
#pragma unroll
            for (int g = 0; g < 16; ++g) Of[qrow * 260 + 32 * u + (g & 3) + 8 * (g >> 2) + 4 * hh] += O[u][g];
        if (hh == 0) Lf[qrow] += lt;
    }
    __syncthreads();
    {
        bf16_t* Y = (bf16_t*)(ws + WS_Y);
        const f32x4 nw = *(const f32x4*)(p.in[14] + h * 256 + 4 * lane);
        const float d1 = wave_sum(p.in[10][lane] * p.in[11][lane] + p.in[10][lane + 64] * p.in[11][lane + 64]);
        const float d2 = wave_sum(p.in[12][lane] * p.in[13][lane] + p.in[12][lane + 64] * p.in[13][lane + 64]);
        const float lam = __expf(d1) - __expf(d2) + 0.2f;
        for (int i = 0; i < 8; ++i) { const int q = 8 * wid + i;
            const float i1 = 1.f / Lf[q], i2 = lam / Lf[64 + q];
            const f32x4 o1 = *(const LAS f32x4*)(Of + q * 260 + 4 * lane), o2 = *(const LAS f32x4*)(Of + (64 + q) * 260 + 4 * lane);
            const f32x4 v = o1 * i1 - o2 * i2;
            const float sq = wave_sum((v[0] * v[0] + v[1] * v[1]) + (v[2] * v[2] + v[3] * v[3]));
            const float rs = rsqrtf(sq * (1.0f / 256.f) + EPS) * 0.8f;
            u32x2 w; w.x = pk2(v[0] * rs * nw[0], v[1] * rs * nw[1]); w.y = pk2(v[2] * rs * nw[2], v[3] * rs * nw[3]);
            *(u32x2*)(Y + (size_t)(64 * c + q) * D + 1024 + h * 256 + 4 * lane) = w; }
    }
    __syncthreads();
}

__global__ void __launch_bounds__(512) hymba_fwd(Params p) {
    extern __shared__ __attribute__((aligned(16))) unsigned char lds_raw[];
    cg::grid_group grid = cg::this_grid();
    lptr lds = (lptr)lds_raw;
    const int G = gridDim.x;
    unsigned char* ws = p.ws;
#define FRESH_TID() int tid = threadIdx.x; asm volatile("" : "+v"(tid))

    if PH(0) { FRESH_TID(); p0_prologue(p, lds, tid, G); }
    grid.sync();
    if PH(1) { pg8::Gemm g{(const bf16_t*)(ws + WS_H1), (const bf16_t*)(ws + WS_WIN), S, NP, D}; pg8::StaticOrder so; so.init(S, NP, G, (int)blockIdx.x);
      pg8::EpiStoreBf16 E{(bf16_t*)(ws + WS_PROJ), NP};
      pg8::gemm_phase<pg8::EpiStoreBf16, true>(lds, g, so, E); }
    grid.sync();
    for (int job = blockIdx.x; job < 640; job += G) { FRESH_TID();
        if (job < 512) { if PH(2) p2_m1_tile(p, lds, job & 3, job >> 2, tid); }
        else { if PH(3) p2_qknorm(p, job - 512, tid); }
    }
    grid.sync();
    if PH(4) for (int job = blockIdx.x; job < 132; job += G) { FRESH_TID(); p3_scan(p, job, tid); }
    grid.sync();
    {
        if PH(5) for (int sj = blockIdx.x; sj < 256; sj += G) { FRESH_TID();
            const int h = sj & 3, c = sj >> 2;
            p4_attn_unit(p, lds, h, 127 - c, tid);
            p4_attn_unit(p, lds, h, c, tid);
        }
    }
    if PH(6) for (int job = blockIdx.x; job < 512; job += G) { FRESH_TID(); p4_m3_tile(p, lds, job & 3, job >> 2, tid); }
    grid.sync();
    if PH(7) { pg8::Gemm g{(const bf16_t*)(ws + WS_Y), (const bf16_t*)(ws + WS_WOUT), S, D, D}; pg8::StaticOrder so; so.init(S, D, G, (int)blockIdx.x);
      pg8::EpiOutProj E{p.in[0], p.out, (bf16_t*)(ws + WS_H1), p.in[16], (float*)(ws + WS_SS)};
      pg8::gemm_phase<pg8::EpiOutProj, true>(lds, g, so, E); }
    grid.sync();
    if PH(8) { pg8::Gemm g{(const bf16_t*)(ws + WS_H1), (const bf16_t*)(ws + WS_WGU), S, NGU, D}; pg8::StaticOrder so; so.init(S, NGU, G, (int)blockIdx.x);
      pg8::EpiSwiGLU E{(bf16_t*)(ws + WS_PROJ), (const float*)(ws + WS_SS)};
      pg8::gemm_phase<pg8::EpiSwiGLU, true>(lds, g, so, E); }
    grid.sync();
    if PH(9) { pg8::Gemm g{(const bf16_t*)(ws + WS_PROJ), (const bf16_t*)(ws + WS_WD), S, D, DFF}; pg8::StaticOrder so; so.init(S, D, G, (int)blockIdx.x);
      pg8::EpiDown E{p.out};
      pg8::gemm_phase<pg8::EpiDown, true>(lds, g, so, E); }
}

extern "C" void kernel_launch(void* const* d_in, const int* in_sizes, int n_in, void* d_out, int out_size, void* d_ws, size_t ws_size, hipStream_t stream) {
    static int grid = 0;
    if (grid == 0) {
        if (n_in != 20 || ws_size < WS_END) { fprintf(stderr, "kernel_launch: unexpected n_in %d / ws_size %zu\n", n_in, ws_size); grid = -1; return; }
        int dev = 0, cus = 0, per_cu = 0;
        hipGetDevice(&dev);
        hipDeviceGetAttribute(&cus, hipDeviceAttributeMultiprocessorCount, dev);
        hipFuncSetAttribute((const void*)hymba_fwd, hipFuncAttributeMaxDynamicSharedMemorySize, LDS_BYTES);
        hipOccupancyMaxActiveBlocksPerMultiprocessor(&per_cu, (const void*)hymba_fwd, 512, LDS_BYTES);
        if (per_cu < 1) { fprintf(stderr, "kernel_launch: occupancy query says %d blocks/CU\n", per_cu); per_cu = 1; }
        grid = cus * per_cu;
        if (grid > 256) grid = 256;
    }
    if (grid < 0) return;
    Params prm{};
    for (int i = 0; i < 20; ++i) prm.in[i] = (const float*)d_in[i];
    prm.out = (float*)d_out; prm.ws = (unsigned char*)d_ws;
    void* args[] = {&prm};
    hipError_t e = hipLaunchCooperativeKernel((const void*)hymba_fwd, dim3(grid), dim3(512), args, LDS_BYTES, stream);
    if (e != hipSuccess) fprintf(stderr, "cooperative launch failed: %s (grid %d)\n", hipGetErrorString(e), grid);
}
```
